# Optimizing an MI355X kernel written in HIP

```python
import math
import jax, jax.numpy as jnp
from jax import lax
import numpy as np

D_MODEL = 1024
BATCH = 4
SEQ = 4096
DEPTH = 1

D_MIX = D_MODEL
LRU_WIDTH = D_MIX // 2
LRU_BLOCKS = 8
LRU_BLOCK = LRU_WIDTH // LRU_BLOCKS
CONV_WIDTH = 4
LRU_C = 8.0
ATT_HEAD_DIM = 64
ATT_WIDTH = D_MIX - LRU_WIDTH
ATT_HEADS = ATT_WIDTH // (2 * ATT_HEAD_DIM)
ATT_V_DIM = 2 * ATT_HEAD_DIM
Q_BLOCK = 128
ROPE_THETA = 10000.0
D_FF = 4 * D_MODEL
NORM_EPS = 1e-6
IN_COLS = 2 * LRU_WIDTH + 3 * ATT_WIDTH

kernel_name = "hymba_style_rglru_diffattn_layer"


def rms_norm(x, g):
    xf = x.astype(jnp.float32)
    y = xf * lax.rsqrt(jnp.mean(xf * xf, axis=-1, keepdims=True) + NORM_EPS)
    return (y * g.astype(jnp.float32)).astype(x.dtype)


def lambda_init(layer_idx):
    return 0.8 - 0.6 * math.exp(-0.3 * layer_idx)


def apply_rope(t, pos):
    half = t.shape[-1] // 2
    freqs = ROPE_THETA ** (-jnp.arange(half, dtype=jnp.float32) / half)
    ang = pos.astype(jnp.float32)[:, None] * freqs[None, :]
    cos = jnp.cos(ang)[None, :, None, None, :]
    sin = jnp.sin(ang)[None, :, None, None, :]
    tf = t.astype(jnp.float32)
    t1, t2 = tf[..., :half], tf[..., half:]
    out = jnp.concatenate([t1 * cos - t2 * sin, t2 * cos + t1 * sin], axis=-1)
    return out.astype(t.dtype)


def rglru_group(u, gate_in, conv_w, conv_b, w_gate_a, b_gate_a, w_gate_x, b_gate_x, lru_lambda):
    B, T, C = u.shape
    xc = lax.conv_general_dilated(
        u, conv_w[:, None, :].astype(u.dtype), window_strides=(1,),
        padding=[(CONV_WIDTH - 1, 0)], dimension_numbers=("NWC", "WIO", "NWC"),
        feature_group_count=C) + conv_b
    xb = xc.reshape(B, T, LRU_BLOCKS, LRU_BLOCK)
    r = jax.nn.sigmoid(jnp.einsum("bthi,hij->bthj", xb, w_gate_a).reshape(B, T, C) + b_gate_a)
    i = jax.nn.sigmoid(jnp.einsum("bthi,hij->bthj", xb, w_gate_x).reshape(B, T, C) + b_gate_x)
    log_a = -LRU_C * r.astype(jnp.float32) * jax.nn.softplus(-lru_lambda.astype(jnp.float32))
    a = jnp.exp(log_a)
    b = jnp.sqrt(-jnp.expm1(2.0 * log_a)) * (i * xc).astype(jnp.float32)

    def combine(e1, e2):
        a1, b1 = e1
        a2, b2 = e2
        return a1 * a2, a2 * b1 + b2

    _, hseq = lax.associative_scan(combine, (a, b), axis=1)
    return hseq.astype(u.dtype) * jax.nn.gelu(gate_in)


def diff_attn_group(q, k, v, lq1, lk1, lq2, lk2, head_gain, lam_init):
    B, T, _ = q.shape
    pos = jnp.arange(T)
    q = apply_rope(q.reshape(B, T, ATT_HEADS, 2, ATT_HEAD_DIM), pos)
    k = apply_rope(k.reshape(B, T, ATT_HEADS, 2, ATT_HEAD_DIM), pos)
    v = v.reshape(B, T, ATT_HEADS, ATT_V_DIM)
    f32 = jnp.float32
    lam = (jnp.exp(jnp.sum(lq1.astype(f32) * lk1.astype(f32)))
           - jnp.exp(jnp.sum(lq2.astype(f32) * lk2.astype(f32))) + lam_init)
    scale = ATT_HEAD_DIM ** -0.5
    nb = T // Q_BLOCK
    qb = q.reshape(B, nb, Q_BLOCK, ATT_HEADS, 2, ATT_HEAD_DIM).transpose(1, 0, 2, 3, 4, 5)
    kpos = jnp.arange(T)

    def one_block(args):
        qblk, bi = args
        s = jnp.einsum("bqhmd,bkhmd->bhmqk", qblk, k).astype(f32) * scale
        qpos = bi * Q_BLOCK + jnp.arange(Q_BLOCK)
        causal = kpos[None, :] <= qpos[:, None]
        s = jnp.where(causal, s, jnp.float32(-1e30))
        p = jax.nn.softmax(s, axis=-1)
        w = p[:, :, 0] - lam * p[:, :, 1]
        return jnp.einsum("bhqk,bkhe->bqhe", w.astype(v.dtype), v)

    o = lax.map(one_block, (qb, jnp.arange(nb)))
    o = o.transpose(1, 0, 2, 3, 4).reshape(B, T, ATT_HEADS, ATT_V_DIM)
    o = rms_norm(o, head_gain) * (1.0 - lam_init)
    return o.reshape(B, T, ATT_WIDTH)


def setup_inputs(seed: int = 0) -> dict:
    key = jax.random.key(seed)
    ks = jax.random.split(key, 24)
    f32 = jnp.float32
    L = DEPTH

    def nrm(k, shape, scale):
        return jax.random.normal(k, shape, f32) * scale

    def gain(k, n):
        return 1.0 + 0.02 * jax.random.normal(k, (L, n), f32)

    u = jax.random.uniform(ks[10], (L, LRU_WIDTH), f32, 0.9, 0.999)
    a0 = u ** (1.0 / LRU_C)
    lru_lambda = jnp.log(a0) - jnp.log1p(-a0)
    return {
        "x": jax.random.normal(ks[0], (BATCH, SEQ, D_MODEL), f32),
        "norm_mix_pre": gain(ks[1], D_MODEL),
        "w_in": nrm(ks[2], (L, D_MODEL, IN_COLS), D_MODEL ** -0.5),
        "conv_w": nrm(ks[3], (L, CONV_WIDTH, LRU_WIDTH), CONV_WIDTH ** -0.5),
        "conv_b": nrm(ks[4], (L, LRU_WIDTH), 0.01),
        "w_gate_a": nrm(ks[5], (L, LRU_BLOCKS, LRU_BLOCK, LRU_BLOCK), LRU_BLOCK ** -0.5),
        "b_gate_a": nrm(ks[6], (L, LRU_WIDTH), 0.01),
        "w_gate_x": nrm(ks[7], (L, LRU_BLOCKS, LRU_BLOCK, LRU_BLOCK), LRU_BLOCK ** -0.5),
        "b_gate_x": nrm(ks[8], (L, LRU_WIDTH), 0.01),
        "lru_lambda": lru_lambda,
        "lambda_q1": nrm(ks[11], (L, ATT_HEAD_DIM), 0.1),
        "lambda_k1": nrm(ks[12], (L, ATT_HEAD_DIM), 0.1),
        "lambda_q2": nrm(ks[13], (L, ATT_HEAD_DIM), 0.1),
        "lambda_k2": nrm(ks[14], (L, ATT_HEAD_DIM), 0.1),
        "att_head_norm": gain(ks[15], ATT_V_DIM),
        "w_out": nrm(ks[16], (L, D_MIX, D_MODEL), D_MIX ** -0.5),
        "norm_mix_post": gain(ks[17], D_MODEL),
        "norm_mlp_pre": gain(ks[18], D_MODEL),
        "w_up": nrm(ks[19], (L, D_MODEL, D_FF), D_MODEL ** -0.5),
        "w_down": nrm(ks[20], (L, D_FF, D_MODEL), D_FF ** -0.5),
        "norm_mlp_post": gain(ks[21], D_MODEL),
    }


def reference(x, norm_mix_pre, w_in, conv_w, conv_b, w_gate_a, b_gate_a, w_gate_x, b_gate_x,
              lru_lambda, lambda_q1, lambda_k1, lambda_q2, lambda_k2, att_head_norm, w_out,
              norm_mix_post, norm_mlp_pre, w_up, w_down, norm_mlp_post):
    splits = [LRU_WIDTH, 2 * LRU_WIDTH, 2 * LRU_WIDTH + ATT_WIDTH, 2 * LRU_WIDTH + 2 * ATT_WIDTH]
    for l in range(DEPTH):
        hn = rms_norm(x, norm_mix_pre[l])
        proj = jnp.einsum("btd,de->bte", hn, w_in[l])
        lru_x, lru_gate, q, k, v = jnp.split(proj, splits, axis=-1)
        y_lru = rglru_group(lru_x, lru_gate, conv_w[l], conv_b[l], w_gate_a[l], b_gate_a[l],
                            w_gate_x[l], b_gate_x[l], lru_lambda[l])
        y_att = diff_attn_group(q, k, v, lambda_q1[l], lambda_k1[l], lambda_q2[l], lambda_k2[l],
                                att_head_norm[l], lambda_init(l))
        mixed = jnp.concatenate([y_lru, y_att], axis=-1)
        x = x + rms_norm(jnp.einsum("bte,ed->btd", mixed, w_out[l]), norm_mix_post[l])
        hm = rms_norm(x, norm_mlp_pre[l])
        act = jnp.square(jax.nn.relu(jnp.einsum("btd,df->btf", hm, w_up[l])))
        x = x + rms_norm(jnp.einsum("btf,fd->btd", act, w_down[l]), norm_mlp_post[l])
    return x
```

```cpp
#include <hip/hip_runtime.h>
#include <cstdio>
#include <cstdint>
#include <cmath>

constexpr int BATCH = 4, T = 4096, D = 1024, M = BATCH * T, LRU_W = 512, ATT_W = 512, NPROJ = 2560, FF = 4096;
constexpr int NHEAD = 4, HD = 64, VD = 128;
constexpr float NORM_EPS = 1e-6f;
constexpr float LAM_INIT = 0.2f;
constexpr float C2 = 0.125f * 1.4426950408889634f;
constexpr int COL_U = 0, COL_G = 512, COL_Q = 1024, COL_K = 1536, COL_V = 2048;

constexpr size_t MiB = 1u << 20;
constexpr size_t WS_CTL = 0, CTL_ZERO_BYTES = 1 * MiB;
constexpr size_t WS_WIN = 2 * MiB, WS_WOUT = 8 * MiB, WS_WUP = 10 * MiB, WS_WDN = 18 * MiB;
constexpr size_t WS_XCH = 26 * MiB;
constexpr size_t WS_ROPE = 28 * MiB;
constexpr size_t WS_AGG = 29 * MiB;
constexpr size_t WS_XN = 32 * MiB;
constexpr size_t WS_PROJ = 64 * MiB;
constexpr size_t WS_O = 144 * MiB;
constexpr size_t WS_ACT = 64 * MiB;
constexpr size_t WS_MIX = 192 * MiB;
constexpr size_t WS_END = 256 * MiB;
constexpr size_t WS_TMP1 = 64 * MiB;
constexpr size_t WS_TMP2 = 192 * MiB;
constexpr size_t WS_LA = 32 * MiB;
constexpr size_t WS_LB = 224 * MiB;

typedef unsigned short bf16;
typedef short bf16x8 __attribute__((ext_vector_type(8)));
typedef float f32x4 __attribute__((ext_vector_type(4)));
typedef unsigned v4u __attribute__((ext_vector_type(4)));

__device__ __forceinline__ unsigned f2bf(float f) { unsigned u = __builtin_bit_cast(unsigned, f); return (u + 0x7fffu + ((u >> 16) & 1u)) >> 16; }
__device__ __forceinline__ unsigned pk2(float lo, float hi) { return f2bf(lo) | (f2bf(hi) << 16); }
__device__ __forceinline__ float bf2f(unsigned h) { return __builtin_bit_cast(float, h << 16); }
__device__ __forceinline__ float wave_sum(float v) {
#pragma unroll
    for (int o = 1; o < 64; o <<= 1) v += __shfl_xor(v, o);
    return v;
}
__device__ __forceinline__ float wave_max(float v) {
#pragma unroll
    for (int o = 1; o < 64; o <<= 1) v = fmaxf(v, __shfl_xor(v, o));
    return v;
}
__device__ __forceinline__ float sigmoidf(float x) { return 1.0f / (1.0f + __expf(-x)); }
__device__ __forceinline__ float gelu_tanh(float x) { const float u = 0.7978845608028654f * (x + 0.044715f * x * x * x); return 0.5f * x * (1.0f + tanhf(u)); }

struct Ptrs {
    const float* in[21]; float* out; unsigned char* ws;
};

__global__ void __launch_bounds__(256) k_transpose(const float* W, int K, int N, bf16* WT) {
    __shared__ float tile[64][65];
    const int k0 = blockIdx.y * 64, n0 = blockIdx.x * 64, tx = threadIdx.x & 63, ty = threadIdx.x >> 6;
    for (int i = ty; i < 64; i += 4) tile[i][tx] = W[(size_t)(k0 + i) * N + n0 + tx];
    __syncthreads();
    for (int i = ty; i < 64; i += 4) WT[(size_t)(n0 + i) * K + k0 + tx] = (bf16)f2bf(tile[tx][i]);
}
__global__ void __launch_bounds__(256) k_rmsnorm_rows(const float* x, const float* g, bf16* xn) {
    const int lane = threadIdx.x & 63, row = blockIdx.x * 4 + (threadIdx.x >> 6);
    const f32x4* xr = (const f32x4*)(x + (size_t)row * D) + lane;
    f32x4 v[4]; float s = 0.f;
#pragma unroll
    for (int j = 0; j < 4; ++j) { v[j] = xr[64 * j]; s += (v[j].x * v[j].x + v[j].y * v[j].y) + (v[j].z * v[j].z + v[j].w * v[j].w); }
    const float r = 1.0f / sqrtf(wave_sum(s) * (1.f / D) + NORM_EPS);
    unsigned long long* o8 = (unsigned long long*)(xn + (size_t)row * D) + lane;
#pragma unroll
    for (int j = 0; j < 4; ++j) { const f32x4 gg = ((const f32x4*)g)[lane + 64 * j];
        o8[64 * j] = (unsigned long long)pk2(v[j].x * r * gg.x, v[j].y * r * gg.y) | ((unsigned long long)pk2(v[j].z * r * gg.z, v[j].w * r * gg.w) << 32); }
}
__global__ void __launch_bounds__(256) k_rope_table(float* tab) {
    const int i = blockIdx.x * 256 + threadIdx.x;
    if (i >= T * 32) return;
    const int pos = i >> 5, j = i & 31;
    const float freq = powf(10000.0f, -(float)j / 32.0f);
    const float ang = (float)pos * freq;
    tab[i] = cosf(ang); tab[T * 32 + i] = sinf(ang);
}

template <class Epi> __global__ void __launch_bounds__(256) k_sgemm(const bf16* A, const bf16* Bt, int K, Epi epi) {
    const int lane = threadIdx.x & 63, w = threadIdx.x >> 6;
    const int m0 = blockIdx.y * 64 + 16 * w, n0 = blockIdx.x * 64;
    f32x4 acc[4];
#pragma unroll
    for (int g = 0; g < 4; ++g) acc[g] = (f32x4){0.f, 0.f, 0.f, 0.f};
    const bf16* ap = A + (size_t)(m0 + (lane & 15)) * K + 8 * (lane >> 4);
    const bf16* bp = Bt + (size_t)(n0 + (lane & 15)) * K + 8 * (lane >> 4);
    for (int k = 0; k < K; k += 32) {
        const bf16x8 a = *(const bf16x8*)(ap + k);
#pragma unroll
        for (int g = 0; g < 4; ++g) { const bf16x8 b = *(const bf16x8*)(bp + (size_t)16 * g * K + k); acc[g] = __builtin_amdgcn_mfma_f32_16x16x32_bf16(a, b, acc[g], 0, 0, 0); }
    }
#pragma unroll
    for (int r = 0; r < 4; ++r) { float v[4] = {acc[0][r], acc[1][r], acc[2][r], acc[3][r]}; epi(m0 + 4 * (lane >> 4) + r, n0, lane & 15, v); }
}
struct EpiProj {
    bf16* P; const float* rope;
    __device__ void operator()(int m, int n0, int c, float (&v)[4]) const {
        float o[4] = {v[0], v[1], v[2], v[3]};
        if (n0 >= COL_Q && n0 < COL_V) {
            const int pos = m % T;
            const float c0 = rope[pos * 32 + c], s0 = rope[T * 32 + pos * 32 + c], c1 = rope[pos * 32 + 16 + c], s1 = rope[T * 32 + pos * 32 + 16 + c];
            o[0] = v[0] * c0 - v[2] * s0; o[2] = v[2] * c0 + v[0] * s0;
            o[1] = v[1] * c1 - v[3] * s1; o[3] = v[3] * c1 + v[1] * s1;
            if (n0 < COL_K) { o[0] *= C2; o[1] *= C2; o[2] *= C2; o[3] *= C2; }
        }
#pragma unroll
        for (int g = 0; g < 4; ++g) P[(size_t)m * NPROJ + n0 + 16 * g + c] = (bf16)f2bf(o[g]);
    }
};
struct EpiF32 { float* C; int ldc; int pad;
    __device__ void operator()(int m, int n0, int c, float (&v)[4]) const {
#pragma unroll
        for (int g = 0; g < 4; ++g) C[(size_t)m * ldc + n0 + 16 * g + c] = v[g]; } };
struct EpiRelu2 { bf16* C; int ldc; int pad;
    __device__ void operator()(int m, int n0, int c, float (&v)[4]) const {
#pragma unroll
        for (int g = 0; g < 4; ++g) { const float r = fmaxf(v[g], 0.f); C[(size_t)m * ldc + n0 + 16 * g + c] = (bf16)f2bf(r * r); } } };

__global__ void __launch_bounds__(256) k_post_norm(const float* tmp, const float* base, const float* g1, float* out, const float* g2, bf16* xn) {
    const int lane = threadIdx.x & 63, row = blockIdx.x * 4 + (threadIdx.x >> 6);
    const f32x4* tr = (const f32x4*)(tmp + (size_t)row * D) + lane;
    const f32x4* br = (const f32x4*)(base + (size_t)row * D) + lane;
    f32x4 v[4]; float s = 0.f;
#pragma unroll
    for (int j = 0; j < 4; ++j) { v[j] = tr[64 * j]; s += (v[j].x * v[j].x + v[j].y * v[j].y) + (v[j].z * v[j].z + v[j].w * v[j].w); }
    const float r = 1.0f / sqrtf(wave_sum(s) * (1.f / D) + NORM_EPS);
    float s2 = 0.f;
#pragma unroll
    for (int j = 0; j < 4; ++j) { const f32x4 gg = ((const f32x4*)g1)[lane + 64 * j]; const f32x4 b = br[64 * j];
        v[j] = b + v[j] * r * gg; s2 += (v[j].x * v[j].x + v[j].y * v[j].y) + (v[j].z * v[j].z + v[j].w * v[j].w); }
    f32x4* orow = (f32x4*)(out + (size_t)row * D) + lane;
#pragma unroll
    for (int j = 0; j < 4; ++j) orow[64 * j] = v[j];
    if (xn) {
        const float r2 = 1.0f / sqrtf(wave_sum(s2) * (1.f / D) + NORM_EPS);
        unsigned long long* o8 = (unsigned long long*)(xn + (size_t)row * D) + lane;
#pragma unroll
        for (int j = 0; j < 4; ++j) { const f32x4 gg = ((const f32x4*)g2)[lane + 64 * j];
            o8[64 * j] = (unsigned long long)pk2(v[j].x * r2 * gg.x, v[j].y * r2 * gg.y) | ((unsigned long long)pk2(v[j].z * r2 * gg.z, v[j].w * r2 * gg.w) << 32); }
    }
}

__global__ void __launch_bounds__(256) k_lru_ab(const bf16* P, const float* conv_w, const float* conv_b, const float* wga, const float* bga, const float* wgx, const float* bgx,
                                                const float* lam, float* LA, float* LB) {
    __shared__ float xc[4][64];
    const int c = threadIdx.x & 63, tt = threadIdx.x >> 6, hb = blockIdx.x, ch = hb * 64 + c;
    const int m = blockIdx.y * 4 + tt, t = m % T;
    float x = conv_b[ch];
#pragma unroll
    for (int w = 0; w < 4; ++w) { const int ts = t - 3 + w; if (ts >= 0) x += conv_w[w * LRU_W + ch] * bf2f(P[(size_t)(m - 3 + w) * NPROJ + COL_U + ch]); }
    xc[tt][c] = x;
    __syncthreads();
    float ra = bga[ch], rx = bgx[ch];
    for (int i = 0; i < 64; ++i) { const float xi = xc[tt][i]; ra += xi * wga[(size_t)(hb * 64 + i) * 64 + c]; rx += xi * wgx[(size_t)(hb * 64 + i) * 64 + c]; }
    const float r = sigmoidf(ra), ig = sigmoidf(rx);
    const float sp = log1pf(expf(-lam[ch]));
    const float log_a = -8.0f * r * sp;
    const float a = expf(log_a);
    const float b = sqrtf(-expm1f(2.0f * log_a)) * (ig * x);
    LA[(size_t)m * LRU_W + ch] = a; LB[(size_t)m * LRU_W + ch] = b;
}
__global__ void __launch_bounds__(64) k_lru_scan(const float* LA, const float* LB, const bf16* P, bf16* MIX) {
    const int ch = blockIdx.x * 64 + threadIdx.x, b = blockIdx.y;
    float h = 0.f;
    for (int t0 = 0; t0 < T; t0 += 16) {
        float a[16], bb[16], g[16];
#pragma unroll
        for (int i = 0; i < 16; ++i) { const size_t m = (size_t)b * T + t0 + i; a[i] = LA[m * LRU_W + ch]; bb[i] = LB[m * LRU_W + ch]; g[i] = bf2f(P[m * NPROJ + COL_G + ch]); }
#pragma unroll
        for (int i = 0; i < 16; ++i) { const size_t m = (size_t)b * T + t0 + i; h = a[i] * h + bb[i]; MIX[m * D + ch] = (bf16)f2bf(h * gelu_tanh(g[i])); }
    }
}

__global__ void __launch_bounds__(256) k_attn_simple(const bf16* P, const float* lq1, const float* lk1, const float* lq2, const float* lk2, const float* hgain, bf16* MIX) {
    __shared__ float qs[4][2][64];
    const int lane = threadIdx.x & 63, w = threadIdx.x >> 6;
    const int gw = blockIdx.x * 4 + w;
    const int qpos = gw % T, bh = gw / T, h = bh % NHEAD, b = bh / NHEAD;
    const size_t mrow = (size_t)b * T + qpos;
    qs[w][0][lane] = bf2f(P[mrow * NPROJ + COL_Q + (h * 2 + 0) * 64 + lane]);
    qs[w][1][lane] = bf2f(P[mrow * NPROJ + COL_Q + (h * 2 + 1) * 64 + lane]);
    const float lam = expf(wave_sum(lq1[lane] * lk1[lane])) - expf(wave_sum(lq2[lane] * lk2[lane])) + LAM_INIT;
    __syncthreads();
    float mx0 = -1e30f, mx1 = -1e30f, l0 = 0.f, l1 = 0.f, a00 = 0.f, a01 = 0.f, a10 = 0.f, a11 = 0.f;
    for (int kt = 0; kt <= qpos / 64; ++kt) {
        const int key = kt * 64 + lane; const bool valid = key <= qpos;
        const bf16* kr = P + ((size_t)b * T + key) * NPROJ + COL_K + (h * 2) * 64;
        float s0 = 0.f, s1 = 0.f;
#pragma unroll
        for (int d8 = 0; d8 < 8; ++d8) { const bf16x8 k0 = *(const bf16x8*)(kr + d8 * 8), k1 = *(const bf16x8*)(kr + 64 + d8 * 8);
#pragma unroll
            for (int j = 0; j < 8; ++j) { s0 += qs[w][0][d8 * 8 + j] * bf2f((unsigned short)k0[j]); s1 += qs[w][1][d8 * 8 + j] * bf2f((unsigned short)k1[j]); } }
        if (!valid) { s0 = -1e30f; s1 = -1e30f; }
        const float n0 = fmaxf(mx0, wave_max(s0)), n1 = fmaxf(mx1, wave_max(s1));
        const float c0 = exp2f(mx0 - n0), c1 = exp2f(mx1 - n1);
        const float p0 = valid ? exp2f(s0 - n0) : 0.f, p1 = valid ? exp2f(s1 - n1) : 0.f;
        l0 = l0 * c0 + wave_sum(p0); l1 = l1 * c1 + wave_sum(p1); mx0 = n0; mx1 = n1;
        a00 *= c0; a01 *= c0; a10 *= c1; a11 *= c1;
        const bf16* vr = P + ((size_t)b * T + kt * 64) * NPROJ + COL_V + h * VD + 2 * lane;
        for (int kk = 0; kk < 64; ++kk) { const float pa = __shfl(p0, kk), pb = __shfl(p1, kk);
            const unsigned vv = *(const unsigned*)(vr + (size_t)kk * NPROJ); const float v0 = bf2f(vv & 0xffffu), v1 = bf2f(vv >> 16);
            a00 += pa * v0; a01 += pa * v1; a10 += pb * v0; a11 += pb * v1; }
    }
    const float o0 = a00 / l0 - lam * (a10 / l1), o1 = a01 / l0 - lam * (a11 / l1);
    const float ms = wave_sum(o0 * o0 + o1 * o1) * (1.f / VD);
    const float r = (1.0f / sqrtf(ms + NORM_EPS)) * (1.0f - LAM_INIT);
    *(unsigned*)(MIX + mrow * D + LRU_W + h * VD + 2 * lane) = pk2(o0 * r * hgain[2 * lane], o1 * r * hgain[2 * lane + 1]);
}

extern "C" void kernel_launch(void* const* d_in, const int* in_sizes, int n_in, void* d_out, int out_size, void* d_ws, size_t ws_size, hipStream_t stream) {
    if (n_in != 21 || in_sizes[0] != M * D || out_size != M * D || ws_size < WS_END) { fprintf(stderr, "kernel_launch: unexpected shapes n_in %d in0 %d out %d ws %zu\n", n_in, n_in > 0 ? in_sizes[0] : -1, out_size, ws_size); return; }
    const float* in[21]; for (int i = 0; i < 21; ++i) in[i] = (const float*)d_in[i];
    unsigned char* ws = (unsigned char*)d_ws; float* out = (float*)d_out;
    bf16* WIN = (bf16*)(ws + WS_WIN); bf16* WOUT = (bf16*)(ws + WS_WOUT); bf16* WUP = (bf16*)(ws + WS_WUP); bf16* WDN = (bf16*)(ws + WS_WDN);
    bf16* XN = (bf16*)(ws + WS_XN); bf16* PROJ = (bf16*)(ws + WS_PROJ); bf16* ACT = (bf16*)(ws + WS_ACT); bf16* MIX = (bf16*)(ws + WS_MIX);
    float* ROPE = (float*)(ws + WS_ROPE);
    k_transpose<<<dim3(NPROJ / 64, D / 64), 256, 0, stream>>>(in[2], D, NPROJ, WIN);
    k_transpose<<<dim3(D / 64, D / 64), 256, 0, stream>>>(in[15], D, D, WOUT);
    k_transpose<<<dim3(FF / 64, D / 64), 256, 0, stream>>>(in[18], D, FF, WUP);
    k_transpose<<<dim3(D / 64, FF / 64), 256, 0, stream>>>(in[19], FF, D, WDN);
    k_rmsnorm_rows<<<M / 4, 256, 0, stream>>>(in[0], in[1], XN);
    k_rope_table<<<T * 32 / 256, 256, 0, stream>>>(ROPE);
    k_sgemm<EpiProj><<<dim3(NPROJ / 64, M / 64), 256, 0, stream>>>(XN, WIN, D, EpiProj{PROJ, ROPE});
    k_lru_ab<<<dim3(8, M / 4), 256, 0, stream>>>(PROJ, in[3], in[4], in[5], in[6], in[7], in[8], in[9], (float*)(ws + WS_LA), (float*)(ws + WS_LB));
    k_lru_scan<<<dim3(LRU_W / 64, BATCH), 64, 0, stream>>>((const float*)(ws + WS_LA), (const float*)(ws + WS_LB), PROJ, MIX);
    k_attn_simple<<<BATCH * NHEAD * T / 4, 256, 0, stream>>>(PROJ, in[10], in[11], in[12], in[13], in[14], MIX);
    k_sgemm<EpiF32><<<dim3(D / 64, M / 64), 256, 0, stream>>>(MIX, WOUT, D, EpiF32{(float*)(ws + WS_TMP1), D, 0});
    k_post_norm<<<M / 4, 256, 0, stream>>>((const float*)(ws + WS_TMP1), in[0], in[16], out, in[17], XN);
    k_sgemm<EpiRelu2><<<dim3(FF / 64, M / 64), 256, 0, stream>>>(XN, WUP, D, EpiRelu2{ACT, FF, 0});
    k_sgemm<EpiF32><<<dim3(D / 64, M / 64), 256, 0, stream>>>(ACT, WDN, FF, EpiF32{(float*)(ws + WS_TMP2), D, 0});
    k_post_norm<<<M / 4, 256, 0, stream>>>((const float*)(ws + WS_TMP2), out, in[20], out, nullptr, nullptr);
}
```
